# Optimizing an MI355X kernel written in HIP

```python
import math
import jax, jax.numpy as jnp
from jax import lax
import numpy as np

D_MODEL = 1024
BATCH = 4
SEQ = 4096
DEPTH = 4
DEC_BATCH = 128
DEC_SEQ = 8
PAST_LEN = 8192
PAGE_SIZE = 128

CHUNK = 128
A_WIDTH = D_MODEL
A_GROUPS = 8
A_GDIM = A_WIDTH // A_GROUPS
N_HEADS = 16
HEAD_DIM = 64
N_KV_HEADS = 4
Q_PER_KV = N_HEADS // N_KV_HEADS
WINDOW = 128
N_BUCKETS = 32
MAX_DISTANCE = 128
D_FF = -(-8 * D_MODEL // (3 * 256)) * 256
DEEPNORM_ALPHA = (2 * DEPTH) ** 0.25
DEEPNORM_BETA = (8 * DEPTH) ** -0.25
LN_EPS = 1e-5
NEG_INF = -1e30

O_U = 0
O_V = O_U + A_WIDTH
O_Q = O_V + A_WIDTH
O_K = O_Q + N_HEADS * HEAD_DIM
O_VV = O_K + N_KV_HEADS * HEAD_DIM
O_G = O_VV + N_KV_HEADS * HEAD_DIM
IN_WIDTH = O_G + 2 * D_MODEL

kernel_name = "hybrid_gmlp_swa_sink_decoder_step"


def layer_norm(x, g, b):
    xf = x.astype(jnp.float32)
    mu = jnp.mean(xf, axis=-1, keepdims=True)
    var = jnp.mean(jnp.square(xf - mu), axis=-1, keepdims=True)
    return ((xf - mu) * lax.rsqrt(var + LN_EPS) * g.astype(jnp.float32) + b.astype(jnp.float32)).astype(x.dtype)


def rel_bucket(dist):
    n = jnp.maximum(dist, 0)
    max_exact = N_BUCKETS // 2
    nf = jnp.maximum(n, 1).astype(jnp.float32)
    large = max_exact + (jnp.log(nf / max_exact) / math.log(MAX_DISTANCE / max_exact)
                         * (N_BUCKETS - max_exact)).astype(jnp.int32)
    large = jnp.minimum(large, N_BUCKETS - 1)
    return jnp.where(n < max_exact, n, large)


def rel_bias_blocks(rel_bias, dist):
    b = rel_bias[rel_bucket(dist)].astype(jnp.float32)
    b = jnp.transpose(b, (2, 0, 1))
    return b.reshape(N_KV_HEADS, Q_PER_KV, dist.shape[0], dist.shape[1])


def sink_attention(q, k, v, bias, mask, sinks):
    s = jnp.einsum('bnqgrd,bnkgd->bngrqk', q, k).astype(jnp.float32) * (HEAD_DIM ** -0.5) + bias
    s = jnp.where(mask[None, :, None, None], s, NEG_INF)
    sink = sinks.astype(jnp.float32).reshape(N_KV_HEADS, Q_PER_KV)[None, None, :, :, None, None]
    m = jnp.maximum(jnp.max(s, axis=-1, keepdims=True), sink)
    p = jnp.exp(s - m)
    p = p / (jnp.sum(p, axis=-1, keepdims=True) + jnp.exp(sink - m))
    return jnp.einsum('bngrqk,bnkgd->bnqgrd', p.astype(v.dtype), v)


def causal_chunk_mask():
    return jnp.tril(jnp.ones((CHUNK, CHUNK), dtype=bool))


def sgu_prompt(u, v, w_s, b_s):
    b, s, _ = v.shape
    vv = v.reshape(b, s // CHUNK, CHUNK, A_GROUPS, A_GDIM)
    w = jnp.where(causal_chunk_mask()[None], w_s, 0.0).astype(v.dtype)
    mixed = jnp.einsum('gts,bcsgd->bctgd', w, vv) + b_s.T.astype(v.dtype)[None, None, :, :, None]
    return u * mixed.reshape(b, s, A_WIDTH)


def sgu_sample(u, v, w_s, b_s):
    b, s, _ = v.shape
    vv = v.reshape(b, s, A_GROUPS, A_GDIM)
    w = jnp.where(causal_chunk_mask()[None], w_s, 0.0)[:, :s, :s].astype(v.dtype)
    mixed = jnp.einsum('gts,bsgd->btgd', w, vv) + b_s[:, :s].T.astype(v.dtype)[None, :, :, None]
    return u * mixed.reshape(b, s, A_WIDTH)


def swa_prompt(q, k, v, bias, mask, sinks):
    b, s = q.shape[0], q.shape[1]
    nb = s // WINDOW
    pad = jnp.zeros((b, WINDOW, N_KV_HEADS, HEAD_DIM), k.dtype)
    kp = jnp.concatenate([pad, k], axis=1)[:, :s]
    vp = jnp.concatenate([pad, v], axis=1)[:, :s]
    blk = lambda t: t.reshape(b, nb, WINDOW, N_KV_HEADS, HEAD_DIM)
    kk = jnp.concatenate([blk(kp), blk(k)], axis=2)
    vv = jnp.concatenate([blk(vp), blk(v)], axis=2)
    qb = q.reshape(b, nb, WINDOW, N_KV_HEADS, Q_PER_KV, HEAD_DIM)
    o = sink_attention(qb, kk, vv, bias, mask, sinks)
    return o.reshape(b, s, N_HEADS * HEAD_DIM)


def swa_sample(q, k_all, v_all, bias, mask, sinks):
    o = sink_attention(q[:, None], k_all[:, None], v_all[:, None], bias, mask, sinks)
    return o[:, 0].reshape(q.shape[0], q.shape[1], N_HEADS * HEAD_DIM)


def trunk_layer(x, w_in, ln_v_g, ln_v_b, w_s, b_s, sinks, w_pa, w_pb, w_o,
                ln1_g, ln1_b, w_gate, w_up, w_down, ln2_g, ln2_b,
                bias, mask, k_buf, v_buf):
    b, s, _ = x.shape
    h = x @ w_in
    u = jax.nn.gelu(h[..., O_U:O_V])
    va = layer_norm(jax.nn.gelu(h[..., O_V:O_Q]), ln_v_g, ln_v_b)
    q = h[..., O_Q:O_K].reshape(b, s, N_KV_HEADS, Q_PER_KV, HEAD_DIM)
    k = h[..., O_K:O_VV].reshape(b, s, N_KV_HEADS, HEAD_DIM)
    v = h[..., O_VV:O_G].reshape(b, s, N_KV_HEADS, HEAD_DIM)
    g_a = jax.nn.sigmoid(h[..., O_G:O_G + D_MODEL])
    g_b = jax.nn.sigmoid(h[..., O_G + D_MODEL:])
    if k_buf is None:
        y_a = sgu_prompt(u, va, w_s, b_s)
        y_b = swa_prompt(q, k, v, bias, mask, sinks)
        new_k, new_v = k[:, -WINDOW:], v[:, -WINDOW:]
    else:
        y_a = sgu_sample(u, va, w_s, b_s)
        k_all = jnp.concatenate([k_buf, k], axis=1)
        v_all = jnp.concatenate([v_buf, v], axis=1)
        y_b = swa_sample(q, k_all, v_all, bias, mask, sinks)
        new_k, new_v = k_all[:, -WINDOW:], v_all[:, -WINDOW:]
    mix = (g_a * (y_a @ w_pa) + g_b * (y_b @ w_pb)) @ w_o
    x = layer_norm(DEEPNORM_ALPHA * x + mix, ln1_g, ln1_b)
    ffn = (jax.nn.silu(x @ w_gate) * (x @ w_up)) @ w_down
    x = layer_norm(DEEPNORM_ALPHA * x + ffn, ln2_g, ln2_b)
    return x, new_k, new_v, va


def setup_inputs(seed: int = 0) -> dict:
    key = jax.random.key(seed)
    ks = jax.random.split(key, 24)
    f32 = jnp.float32
    nrm = lambda k, shp, sc: jax.random.normal(k, shp, f32) * sc
    return {
        "x_prompt": nrm(ks[0], (BATCH, SEQ, D_MODEL), 1.0),
        "x_sample": nrm(ks[1], (DEC_BATCH, DEC_SEQ, D_MODEL), 1.0),
        "cache_swa_k": nrm(ks[2], (DEPTH, DEC_BATCH, WINDOW, N_KV_HEADS, HEAD_DIM), 1.0),
        "cache_swa_v": nrm(ks[3], (DEPTH, DEC_BATCH, WINDOW, N_KV_HEADS, HEAD_DIM), 1.0),
        "rel_bias": nrm(ks[4], (N_BUCKETS, N_HEADS), 0.5),
        "w_in": nrm(ks[5], (DEPTH, D_MODEL, IN_WIDTH), D_MODEL ** -0.5),
        "ln_v_g": 1.0 + nrm(ks[6], (DEPTH, A_WIDTH), 0.05),
        "ln_v_b": nrm(ks[7], (DEPTH, A_WIDTH), 0.02),
        "w_s": nrm(ks[8], (DEPTH, A_GROUPS, CHUNK, CHUNK), CHUNK ** -0.5),
        "b_s": 1.0 + nrm(ks[9], (DEPTH, A_GROUPS, CHUNK), 0.1),
        "sinks": nrm(ks[10], (DEPTH, N_HEADS), 0.5),
        "w_pa": nrm(ks[11], (DEPTH, A_WIDTH, D_MODEL), A_WIDTH ** -0.5),
        "w_pb": nrm(ks[12], (DEPTH, N_HEADS * HEAD_DIM, D_MODEL), (N_HEADS * HEAD_DIM) ** -0.5),
        "w_o": nrm(ks[13], (DEPTH, D_MODEL, D_MODEL), DEEPNORM_BETA * D_MODEL ** -0.5),
        "ln1_g": 1.0 + nrm(ks[14], (DEPTH, D_MODEL), 0.05),
        "ln1_b": nrm(ks[15], (DEPTH, D_MODEL), 0.02),
        "w_gate": nrm(ks[16], (DEPTH, D_MODEL, D_FF), D_MODEL ** -0.5),
        "w_up": nrm(ks[17], (DEPTH, D_MODEL, D_FF), D_MODEL ** -0.5),
        "w_down": nrm(ks[18], (DEPTH, D_FF, D_MODEL), DEEPNORM_BETA * D_FF ** -0.5),
        "ln2_g": 1.0 + nrm(ks[19], (DEPTH, D_MODEL), 0.05),
        "ln2_b": nrm(ks[20], (DEPTH, D_MODEL), 0.02),
    }


def reference(x_prompt, x_sample, cache_swa_k, cache_swa_v, rel_bias, w_in, ln_v_g, ln_v_b,
              w_s, b_s, sinks, w_pa, w_pb, w_o, ln1_g, ln1_b, w_gate, w_up, w_down,
              ln2_g, ln2_b):
    n_blocks = x_prompt.shape[1] // WINDOW
    qi = jnp.arange(WINDOW, dtype=jnp.int32)[:, None]
    kj = jnp.arange(2 * WINDOW, dtype=jnp.int32)[None, :]
    dist_p = qi + WINDOW - kj
    bias_p = rel_bias_blocks(rel_bias, dist_p)
    blk = jnp.arange(n_blocks, dtype=jnp.int32)[:, None, None]
    mask_p = (dist_p >= 0)[None] & (dist_p < WINDOW)[None] & ((blk - 1) * WINDOW + kj[None] >= 0)
    n_new = x_sample.shape[1]
    qs = jnp.arange(n_new, dtype=jnp.int32)[:, None]
    ksj = jnp.arange(WINDOW + n_new, dtype=jnp.int32)[None, :]
    dist_s = qs + WINDOW - ksj
    bias_s = rel_bias_blocks(rel_bias, dist_s)
    mask_s = ((dist_s >= 0) & (dist_s < WINDOW))[None]

    xp, xs = x_prompt, x_sample
    kp_l, vp_l, ks_l, vs_l, ga_l = [], [], [], [], []
    for l in range(DEPTH):
        w = (w_in[l], ln_v_g[l], ln_v_b[l], w_s[l], b_s[l], sinks[l], w_pa[l], w_pb[l], w_o[l],
             ln1_g[l], ln1_b[l], w_gate[l], w_up[l], w_down[l], ln2_g[l], ln2_b[l])
        xp, kp, vp, _ = trunk_layer(xp, *w, bias_p, mask_p, None, None)
        xs, kn, vn, va_s = trunk_layer(xs, *w, bias_s, mask_s, cache_swa_k[l], cache_swa_v[l])
        kp_l.append(kp); vp_l.append(vp); ks_l.append(kn); vs_l.append(vn); ga_l.append(va_s)
    swa_k_prompt = jnp.stack(kp_l)
    swa_v_prompt = jnp.stack(vp_l)
    swa_k_sample = jnp.stack(ks_l)
    swa_v_sample = jnp.stack(vs_l)
    gmlp_v_sample = jnp.stack(ga_l)
    return (xp, xs, swa_k_prompt, swa_v_prompt, swa_k_sample, swa_v_sample, gmlp_v_sample)
```

```cpp
#include <hip/hip_runtime.h>
#include <hip/hip_cooperative_groups.h>
#include <cstdio>
#include <cstdint>
namespace cg = cooperative_groups;
namespace pg8 {
#define PG8_LAS __attribute__((address_space(3)))
typedef unsigned short bf16_t;
typedef short bf16x8 __attribute__((ext_vector_type(8)));
typedef float f32x4 __attribute__((ext_vector_type(4)));
typedef unsigned u32x4 __attribute__((ext_vector_type(4)));
constexpr int BM = 256, BK = 64, HALF = 128, HTB = HALF * BK * 2  , STAGE_BYTES = 8 * HTB, NXCD = 8, WGM = 8;

__host__ __device__ __forceinline__ int lds_byte(int r, int c) { const int st = (r >> 4) * 2 + (c >> 5), rr = r & 15, cc = c & 31, ob = rr * 64 + cc * 2; return st * 1024 + (ob ^ (((ob >> 9) & 1) << 5)); }
__host__ __device__ __forceinline__ void stage_rc(int b, int& R, int& C) { const int st = b / 1024, sb = b % 1024, swz = sb ^ (((sb >> 9) & 1) << 5); R = (st >> 1) * 16 + swz / 64; C = (st & 1) * 32 + (swz % 64) / 2; }
__host__ __device__ __forceinline__ int perm32(int rho) { const int n = rho >> 4, i = rho & 15; return 8 * (i >> 2) + 4 * n + (i & 3); }

struct Unit { int pm, pn; };
struct Gemm { const bf16_t* A; const bf16_t* Bt; int M, N, K; };

struct StaticOrder {
    int nM, nN, nwg, G, c;
    __host__ __device__ void init(int M, int N, int G_, int c_) { nM = M / BM; nN = N / BM; nwg = nM * nN; G = G_; c = c_; }
    __host__ __device__ bool next(int i, Unit& u) const {
        const long L = (long)i * G + c; if (L >= nwg) return false;
        int wgid = (int)L; { const int q = nwg / NXCD, r = nwg % NXCD, xcd = wgid % NXCD, off = wgid / NXCD; wgid = (xcd < r ? xcd * (q + 1) : r * (q + 1) + (xcd - r) * q) + off; }
        const int nig = WGM * nN, gid = wgid / nig, fm = gid * WGM, gsz = (nM - fm) < WGM ? (nM - fm) : WGM;
        u.pm = fm + ((wgid % nig) % gsz); u.pn = (wgid % nig) / gsz; return true;
    }
    __device__ __forceinline__ void a_ready(const Unit&) const {}
    __device__ __forceinline__ void done(const Unit&) const {}
};


typedef float f32x2 __attribute__((ext_vector_type(2)));
__device__ __forceinline__ unsigned cvt_pk_bf16(float lo, float hi) { unsigned r; asm volatile("v_cvt_pk_bf16_f32 %0, %1, %2" : "=v"(r) : "v"(lo), "v"(hi)); return r; }
__device__ __forceinline__ float bf_lo(unsigned w) { return __uint_as_float(w << 16); }
__device__ __forceinline__ float bf_hi(unsigned w) { return __uint_as_float(w & 0xffff0000u); }
__device__ __forceinline__ float fast_sigmoid(float x) { return __builtin_amdgcn_rcpf(1.0f + __builtin_amdgcn_exp2f(-1.4426950408889634f * x)); }
__device__ __forceinline__ float gelu_tanh(float x) { const float z = x * (1.0f + 0.044715f * x * x); return x * __builtin_amdgcn_rcpf(1.0f + __builtin_amdgcn_exp2f(-2.3022081986f * z)); }
__device__ __forceinline__ u32x4 pack8(const f32x4 a, const f32x4 b) { u32x4 w; w.x = cvt_pk_bf16(a[0], a[1]); w.y = cvt_pk_bf16(a[2], a[3]); w.z = cvt_pk_bf16(b[0], b[1]); w.w = cvt_pk_bf16(b[2], b[3]); return w; }

constexpr int NTOK = 17408, NPROMPT = 16384;
constexpr float QSCALE = 0.125f * 1.4426950408889634f;

struct EpiH {
    static constexpr bool PERM = true, AFTER_DRAIN = false;
    bf16_t *U, *VG, *Q, *KB, *VB, *GA, *GB; float* VST; float *okp, *ovp, *oks, *ovs;
    __device__ __forceinline__ void operator()(const f32x4 (&acc)[2][2][4][2], const Unit& u, int wr, int wc, int fr, int fq) const {
        const int pn = u.pn, row0 = u.pm * BM + wr * 64 + fr, cw = wc * 32 + 8 * fq;
        if (pn < 4 || (pn >= 8 && pn < 12) || pn >= 14) {
            bf16_t* base; int mode;
            if (pn < 4) { base = U + pn * BM; mode = 0; } else if (pn < 12) { base = Q + (pn - 8) * BM; mode = 1; } else if (pn < 18) { base = GA + (pn - 14) * BM; mode = 2; } else { base = GB + (pn - 18) * BM; mode = 2; }
#pragma unroll
            for (int ai = 0; ai < 2; ++ai)
#pragma unroll
                for (int m = 0; m < 4; ++m) { bf16_t* rowp = base + (size_t)(row0 + ai * HALF + m * 16) * 1024 + cw;
#pragma unroll
                    for (int bj = 0; bj < 2; ++bj) { f32x4 v0 = acc[ai][bj][m][0], v1 = acc[ai][bj][m][1];
                        if (mode == 0) {
#pragma unroll
                            for (int e = 0; e < 4; ++e) { v0[e] = gelu_tanh(v0[e]); v1[e] = gelu_tanh(v1[e]); }
                        } else if (mode == 1) { v0 = v0 * QSCALE; v1 = v1 * QSCALE; }
                        else {
#pragma unroll
                            for (int e = 0; e < 4; ++e) { v0[e] = fast_sigmoid(v0[e]); v1[e] = fast_sigmoid(v1[e]); }
                        }
                        *(u32x4*)(rowp + bj * HALF) = pack8(v0, v1); } }
        } else if (pn < 8) {
            bf16_t* base = VG + (pn - 4) * BM;
#pragma unroll
            for (int ai = 0; ai < 2; ++ai)
#pragma unroll
                for (int m = 0; m < 4; ++m) { const int row = row0 + ai * HALF + m * 16; bf16_t* rowp = base + (size_t)row * 1024 + cw;
                    f32x4 g[2][2]; float s = 0.f;
#pragma unroll
                    for (int bj = 0; bj < 2; ++bj)
#pragma unroll
                        for (int n = 0; n < 2; ++n) {
#pragma unroll
                            for (int e = 0; e < 4; ++e) g[bj][n][e] = gelu_tanh(acc[ai][bj][m][n][e]);
                            s += (g[bj][n][0] + g[bj][n][1]) + (g[bj][n][2] + g[bj][n][3]); }
                    s += __shfl_xor(s, 16); s += __shfl_xor(s, 32);
                    const float mw = s * (1.0f / 64.0f); float q = 0.f;
#pragma unroll
                    for (int bj = 0; bj < 2; ++bj)
#pragma unroll
                        for (int n = 0; n < 2; ++n) { const f32x4 d = g[bj][n] - mw; q += (d[0] * d[0] + d[1] * d[1]) + (d[2] * d[2] + d[3] * d[3]); }
                    q += __shfl_xor(q, 16); q += __shfl_xor(q, 32);
                    if (fq == 0) { f32x2 st; st.x = mw; st.y = q; *(f32x2*)(VST + ((size_t)row * 16 + (pn - 4) * 4 + wc) * 2) = st; }
#pragma unroll
                    for (int bj = 0; bj < 2; ++bj) *(u32x4*)(rowp + bj * HALF) = pack8(g[bj][0], g[bj][1]); }
        } else {
            bf16_t* base = (pn == 12) ? KB : VB; float* op = (pn == 12) ? okp : ovp; float* os = (pn == 12) ? oks : ovs;
#pragma unroll
            for (int ai = 0; ai < 2; ++ai)
#pragma unroll
                for (int m = 0; m < 4; ++m) { const int row = row0 + ai * HALF + m * 16; bf16_t* rowp = base + (size_t)row * 256 + cw;
                    float* fo = nullptr;
                    if (row < NPROMPT) { const int t = row & 4095; if (t >= 3968) fo = op + ((size_t)(row >> 12) * 128 + (t - 3968)) * 256 + cw; }
                    else { const int sr = row - NPROMPT; fo = os + ((size_t)(sr >> 3) * 128 + 120 + (sr & 7)) * 256 + cw; }
#pragma unroll
                    for (int bj = 0; bj < 2; ++bj) { const f32x4 v0 = acc[ai][bj][m][0], v1 = acc[ai][bj][m][1];
                        *(u32x4*)(rowp + bj * HALF) = pack8(v0, v1);
                        if (fo) { *(f32x4*)(fo + bj * HALF) = v0; *(f32x4*)(fo + bj * HALF + 4) = v1; } } }
        }
    }
};
template <bool ADD> struct EpiGate {
    static constexpr bool PERM = true, AFTER_DRAIN = false;
    const bf16_t* G; bf16_t* T;
    __device__ __forceinline__ void operator()(const f32x4 (&acc)[2][2][4][2], const Unit& u, int wr, int wc, int fr, int fq) const {
        const int row0 = u.pm * BM + wr * 64 + fr, col0 = u.pn * BM + wc * 32 + 8 * fq;
#pragma unroll
        for (int ai = 0; ai < 2; ++ai)
#pragma unroll
            for (int m = 0; m < 4; ++m) { const size_t off = (size_t)(row0 + ai * HALF + m * 16) * 1024 + col0;
#pragma unroll
                for (int bj = 0; bj < 2; ++bj) { const u32x4 gw = *(const u32x4*)(G + off + bj * HALF);
                    f32x4 g0, g1; g0[0] = bf_lo(gw.x); g0[1] = bf_hi(gw.x); g0[2] = bf_lo(gw.y); g0[3] = bf_hi(gw.y); g1[0] = bf_lo(gw.z); g1[1] = bf_hi(gw.z); g1[2] = bf_lo(gw.w); g1[3] = bf_hi(gw.w);
                    f32x4 v0 = acc[ai][bj][m][0] * g0, v1 = acc[ai][bj][m][1] * g1;
                    if (ADD) { const u32x4 tw = *(const u32x4*)(T + off + bj * HALF);
                        f32x4 t0, t1; t0[0] = bf_lo(tw.x); t0[1] = bf_hi(tw.x); t0[2] = bf_lo(tw.y); t0[3] = bf_hi(tw.y); t1[0] = bf_lo(tw.z); t1[1] = bf_hi(tw.z); t1[2] = bf_lo(tw.w); t1[3] = bf_hi(tw.w);
                        v0 = v0 + t0; v1 = v1 + t1; }
                    *(u32x4*)(T + off + bj * HALF) = pack8(v0, v1); } }
    }
};
struct EpiRes {
    static constexpr bool PERM = true, AFTER_DRAIN = false;
    const float* resP; const float* resS; float* Z; float alpha;
    __device__ __forceinline__ void operator()(const f32x4 (&acc)[2][2][4][2], const Unit& u, int wr, int wc, int fr, int fq) const {
        const int row0 = u.pm * BM + wr * 64 + fr, col0 = u.pn * BM + wc * 32 + 8 * fq;
        const float* rb = (u.pm < NPROMPT / BM) ? resP : resS - (size_t)NPROMPT * 1024;
#pragma unroll
        for (int ai = 0; ai < 2; ++ai)
#pragma unroll
            for (int m = 0; m < 4; ++m) { const size_t off = (size_t)(row0 + ai * HALF + m * 16) * 1024 + col0;
#pragma unroll
                for (int bj = 0; bj < 2; ++bj) { const f32x4 x0 = *(const f32x4*)(rb + off + bj * HALF), x1 = *(const f32x4*)(rb + off + bj * HALF + 4);
                    *(f32x4*)(Z + off + bj * HALF) = x0 * alpha + acc[ai][bj][m][0]; *(f32x4*)(Z + off + bj * HALF + 4) = x1 * alpha + acc[ai][bj][m][1]; } }
    }
};
struct EpiSwiGLU {
    static constexpr bool PERM = true, AFTER_DRAIN = false;
    bf16_t* HID;
    __device__ __forceinline__ void operator()(const f32x4 (&acc)[2][2][4][2], const Unit& u, int wr, int wc, int fr, int fq) const {
        const int row0 = u.pm * BM + wr * 64 + fr, col0 = u.pn * HALF + wc * 32 + 8 * fq;
#pragma unroll
        for (int ai = 0; ai < 2; ++ai)
#pragma unroll
            for (int m = 0; m < 4; ++m) { f32x4 v0, v1;
#pragma unroll
                for (int e = 0; e < 4; ++e) { const float g0 = acc[ai][0][m][0][e], g1 = acc[ai][0][m][1][e];
                    v0[e] = g0 * fast_sigmoid(g0) * acc[ai][1][m][0][e]; v1[e] = g1 * fast_sigmoid(g1) * acc[ai][1][m][1][e]; }
                *(u32x4*)(HID + (size_t)(row0 + ai * HALF + m * 16) * 2816 + col0) = pack8(v0, v1); }
    }
};

template <class Epi, class Sched, bool ALIGN_EPI = false, bool SP2 = false>
__device__ __forceinline__ void gemm_phase(PG8_LAS unsigned char* lds, const Gemm g, const Sched& S, const Epi& E) {
    int tid_ = threadIdx.x; asm volatile("" : "+v"(tid_));
    const int tid = tid_, wid = __builtin_amdgcn_readfirstlane(tid >> 6), lane = tid & 63, wr = wid >> 2, wc = wid & 3, fr = lane & 15, fq = lane >> 4;
    const int K = g.K, nt = K / BK;
    unsigned voffA[2], voffB[2];
#pragma unroll
    for (int i = 0; i < 2; ++i) { int R, C; stage_rc(tid * 16 + i * 8192, R, C); const int Rb = Epi::PERM ? ((R & ~31) + perm32(R & 31)) : R;
        voffA[i] = (unsigned)(R * K + C) * 2u; voffB[i] = (unsigned)(Rb * K + C) * 2u; }
    const size_t kstep = (size_t)(BK * 2);
    const size_t hstep = (size_t)HALF * K * 2;
    const size_t tstep = 2 * hstep;
    const unsigned ldsw = (unsigned)wid * 1024u;
    const int aoff = lds_byte(wr * 64 + fr, fq * 8), boff = lds_byte(wc * 32 + fr, fq * 8);
#define PG8_SA(b, h) (((b) * 2 + (h)) * HTB)
#define PG8_SB(b, h) ((4 + (b) * 2 + (h)) * HTB)
#define PG8_STAGE(bufoff, gbase, voff) do { _Pragma("unroll") for (int _i = 0; _i < 2; ++_i) \
        __builtin_amdgcn_global_load_lds((const unsigned*)((const char*)(gbase) + (voff)[_i]), (PG8_LAS unsigned*)(lds + (bufoff) + ldsw + _i * 8192), 16, 0, 0); } while (0)
#define PG8_LDA(dst, b, h) do { _Pragma("unroll") for (int m = 0; m < 4; ++m) _Pragma("unroll") for (int k = 0; k < 2; ++k) dst[m][k] = *(const PG8_LAS bf16x8*)(lds + PG8_SA(b, h) + aoff + m * 2048 + k * 1024); } while (0)
#define PG8_LDB(dst, b, h) do { _Pragma("unroll") for (int n = 0; n < 2; ++n) _Pragma("unroll") for (int k = 0; k < 2; ++k) dst[n][k] = *(const PG8_LAS bf16x8*)(lds + PG8_SB(b, h) + boff + n * 2048 + k * 1024); } while (0)
#define PG8_MMA(ai, bj, At, Bt) do { __builtin_amdgcn_s_setprio(1); _Pragma("unroll") for (int m = 0; m < 4; ++m) _Pragma("unroll") for (int n = 0; n < 2; ++n) _Pragma("unroll") for (int k = 0; k < 2; ++k) \
        acc[ai][bj][m][n] = __builtin_amdgcn_mfma_f32_16x16x32_bf16(Bt[n][k], At[m][k], acc[ai][bj][m][n], 0, 0, 0); __builtin_amdgcn_s_setprio(0); } while (0)
#define PG8_WAIT_V(n) asm volatile("s_waitcnt vmcnt(" #n ")" ::: "memory")
#define PG8_WAIT_L(n) asm volatile("s_waitcnt lgkmcnt(" #n ")" ::: "memory")
#define PG8_BAR __builtin_amdgcn_s_barrier()
#define PG8_SCHED __builtin_amdgcn_sched_barrier(0)
    Unit cur, nxt; int ui = 0;
    if (!S.next(0, cur)) return;
    f32x4 acc[2][2][4][2];
#pragma unroll
    for (int a = 0; a < 2; ++a)
#pragma unroll
        for (int b = 0; b < 2; ++b)
#pragma unroll
            for (int m = 0; m < 4; ++m)
#pragma unroll
                for (int n = 0; n < 2; ++n) acc[a][b][m][n] = (f32x4){0.f, 0.f, 0.f, 0.f};
    bf16x8 At[4][2], B0[2][2], B1[2][2];
    const char* cA = (const char*)g.A + (size_t)cur.pm * tstep; const char* cB = (const char*)g.Bt + (size_t)cur.pn * tstep;
    S.a_ready(cur);
    if constexpr (SP2) {
        PG8_STAGE(PG8_SB(0, 0), cB, voffB); PG8_STAGE(PG8_SB(0, 1), cB + hstep, voffB); PG8_STAGE(PG8_SA(0, 0), cA, voffA); PG8_STAGE(PG8_SA(0, 1), cA + hstep, voffA);
        if (wr == 1) PG8_BAR;
        PG8_WAIT_V(2); PG8_BAR;
        PG8_STAGE(PG8_SB(1, 0), cB + kstep, voffB); PG8_STAGE(PG8_SA(1, 0), cA + kstep, voffA); PG8_STAGE(PG8_SB(1, 1), cB + hstep + kstep, voffB);
        PG8_WAIT_V(6); PG8_BAR;
    } else {
        PG8_STAGE(PG8_SB(0, 0), cB, voffB); PG8_STAGE(PG8_SA(0, 0), cA, voffA); PG8_STAGE(PG8_SB(0, 1), cB + hstep, voffB); PG8_STAGE(PG8_SA(0, 1), cA + hstep, voffA);
        if (wr == 1) PG8_BAR;
        PG8_WAIT_V(4); PG8_BAR;
        PG8_STAGE(PG8_SB(1, 0), cB + kstep, voffB); PG8_STAGE(PG8_SA(1, 0), cA + kstep, voffA); PG8_STAGE(PG8_SB(1, 1), cB + hstep + kstep, voffB);
        PG8_WAIT_V(6); PG8_BAR;
    }
    for (;;) {
        const bool has_next = S.next(ui + 1, nxt);
        const char* nA = has_next ? (const char*)g.A + (size_t)nxt.pm * tstep : cA; const char* nB = has_next ? (const char*)g.Bt + (size_t)nxt.pn * tstep : cB;
        for (int t = 0; t < nt; t += 2) {
            const bool last = (t == nt - 2);
            const char* a1 = cA + (size_t)(t + 1) * kstep;
            const char* a2 = last ? nA : cA + (size_t)(t + 2) * kstep; const char* b2 = last ? nB : cB + (size_t)(t + 2) * kstep;
            const char* a3 = a2 + kstep; const char* b3 = b2 + kstep;
            if (last && has_next) S.a_ready(nxt);
            if constexpr (SP2) {
            PG8_LDB(B0, 0, 0); PG8_LDB(B1, 0, 1); PG8_SCHED; PG8_LDA(At, 0, 0); PG8_STAGE(PG8_SA(1, 1), a1 + hstep, voffA);
            PG8_WAIT_V(8); PG8_WAIT_L(0); PG8_BAR; PG8_MMA(0, 0, At, B0); PG8_MMA(0, 1, At, B1); PG8_BAR; PG8_SCHED;
            PG8_LDA(At, 0, 1); PG8_STAGE(PG8_SB(0, 0), b2, voffB); PG8_STAGE(PG8_SB(0, 1), b2 + hstep, voffB); PG8_STAGE(PG8_SA(0, 0), a2, voffA);
            PG8_WAIT_V(8); PG8_WAIT_L(0); PG8_BAR; PG8_MMA(1, 0, At, B0); PG8_MMA(1, 1, At, B1); PG8_BAR; PG8_SCHED;
            PG8_LDB(B0, 1, 0); PG8_LDB(B1, 1, 1); PG8_SCHED; PG8_LDA(At, 1, 0); PG8_STAGE(PG8_SA(0, 1), a2 + hstep, voffA);
            PG8_WAIT_V(8); PG8_WAIT_L(0); PG8_BAR; PG8_MMA(0, 0, At, B0); PG8_MMA(0, 1, At, B1); PG8_BAR; PG8_SCHED;
            PG8_LDA(At, 1, 1); PG8_STAGE(PG8_SB(1, 0), b3, voffB); PG8_STAGE(PG8_SB(1, 1), b3 + hstep, voffB); PG8_STAGE(PG8_SA(1, 0), a3, voffA);
            PG8_WAIT_V(8); PG8_WAIT_L(0); PG8_BAR; PG8_MMA(1, 0, At, B0); PG8_MMA(1, 1, At, B1); PG8_BAR; PG8_SCHED;
            } else {
            PG8_LDB(B0, 0, 0); PG8_SCHED; PG8_LDA(At, 0, 0); PG8_STAGE(PG8_SA(1, 1), a1 + hstep, voffA);
            PG8_WAIT_L(8); PG8_BAR; PG8_WAIT_L(0); PG8_MMA(0, 0, At, B0); PG8_BAR; PG8_SCHED;
            PG8_LDB(B1, 0, 1); PG8_STAGE(PG8_SB(0, 0), b2, voffB);
            PG8_BAR; PG8_WAIT_L(0); PG8_MMA(0, 1, At, B1); PG8_BAR;
            PG8_LDA(At, 0, 1); PG8_STAGE(PG8_SA(0, 0), a2, voffA);
            PG8_BAR; PG8_WAIT_L(0); PG8_MMA(1, 0, At, B0); PG8_BAR; PG8_SCHED;
            PG8_STAGE(PG8_SB(0, 1), b2 + hstep, voffB);
            PG8_WAIT_V(6); PG8_BAR; PG8_MMA(1, 1, At, B1); PG8_BAR;
            PG8_LDB(B0, 1, 0); PG8_SCHED; PG8_LDA(At, 1, 0); PG8_STAGE(PG8_SA(0, 1), a2 + hstep, voffA);
            PG8_WAIT_L(8); PG8_BAR; PG8_WAIT_L(0); PG8_MMA(0, 0, At, B0); PG8_BAR; PG8_SCHED;
            PG8_LDB(B1, 1, 1); PG8_STAGE(PG8_SB(1, 0), b3, voffB);
            PG8_BAR; PG8_WAIT_L(0); PG8_MMA(0, 1, At, B1); PG8_BAR;
            PG8_LDA(At, 1, 1); PG8_STAGE(PG8_SA(1, 0), a3, voffA);
            PG8_BAR; PG8_WAIT_L(0); PG8_MMA(1, 0, At, B0); PG8_BAR; PG8_SCHED;
            PG8_STAGE(PG8_SB(1, 1), b3 + hstep, voffB);
            PG8_WAIT_V(6); PG8_BAR; PG8_MMA(1, 1, At, B1); PG8_BAR;
            }
        }
        if constexpr (ALIGN_EPI) { if (wr == 0) PG8_BAR; }
        if constexpr (!Epi::AFTER_DRAIN) { E(acc, cur, wr, wc, fr, fq); S.done(cur); }
        if (!has_next) break;
#pragma unroll
        for (int a = 0; a < 2; ++a)
#pragma unroll
            for (int b = 0; b < 2; ++b)
#pragma unroll
                for (int m = 0; m < 4; ++m)
#pragma unroll
                    for (int n = 0; n < 2; ++n) acc[a][b][m][n] = (f32x4){0.f, 0.f, 0.f, 0.f};
        cur = nxt; cA = nA; cB = nB; ++ui;
        if constexpr (ALIGN_EPI) { if (wr == 1) PG8_BAR; }
    }
    PG8_WAIT_V(0);
    if constexpr (!ALIGN_EPI) { if (wr == 0) PG8_BAR; }
    PG8_BAR;
    if constexpr (Epi::AFTER_DRAIN) { E.fused(acc, cur, wr, wc, fr, fq, lds, wid, lane); S.done(cur); }
#undef PG8_SA
#undef PG8_SB
#undef PG8_STAGE
#undef PG8_LDA
#undef PG8_LDB
#undef PG8_MMA
#undef PG8_WAIT_V
#undef PG8_WAIT_L
#undef PG8_BAR
#undef PG8_SCHED
}
}

#define LAS __attribute__((address_space(3)))
using pg8::bf16_t; using pg8::bf16x8; using pg8::f32x4; using pg8::u32x4; using pg8::f32x2;
typedef float f32x16 __attribute__((ext_vector_type(16)));
typedef short s16x4 __attribute__((ext_vector_type(4)));
typedef unsigned u32x2 __attribute__((ext_vector_type(2)));
#define MFMA32(a, b, c) __builtin_amdgcn_mfma_f32_32x32x16_bf16((a), (b), (c), 0, 0, 0)

constexpr int NWAVES = 8, NTHR = 512;
constexpr int D = 1024, NTOK = pg8::NTOK, NPROMPT = pg8::NPROMPT, SEQ = 4096, DEPTH = 4, INW = 5632, FF = 2816, DB = 128, DS = 8;
constexpr float LN_EPS = 1e-5f, ALPHA = 1.681792830507429f  , LOG2E = 1.4426950408889634f;
constexpr size_t MiB = 1u << 20;
constexpr size_t W_IN_B = (size_t)INW * D * 2, W_SQ_B = (size_t)D * D * 2, W_GU_B = (size_t)2 * FF * D * 2, W_DN_B = (size_t)D * FF * 2;
constexpr size_t W_LAYER_B = W_IN_B + 3 * W_SQ_B + W_GU_B + W_DN_B;
constexpr size_t WS_W = 2 * MiB;
constexpr size_t ACT_B = (size_t)NTOK * D * 2;
constexpr size_t WS_XB = WS_W + DEPTH * W_LAYER_B;
constexpr size_t WS_U = WS_XB + ACT_B, WS_VG = WS_U + ACT_B, WS_Q = WS_VG + ACT_B;
constexpr size_t KV_B = (size_t)NTOK * 256 * 2;
constexpr size_t WS_KB = WS_Q + ACT_B, WS_VB = WS_KB + KV_B, WS_GA = WS_VB + KV_B, WS_GB = WS_GA + ACT_B;
constexpr size_t WS_VST = WS_GB + ACT_B;
constexpr size_t WS_END = WS_VST + (size_t)NTOK * 16 * 8;
constexpr size_t WS_HID = WS_U;
constexpr size_t WS_T = WS_VG;
constexpr size_t WS_Z = WS_GA;
static_assert((size_t)NTOK * FF * 2 <= 3 * ACT_B, "HID overlay");
constexpr size_t O_Y = 0, O_KP = (size_t)NTOK * D, O_VP = O_KP + (size_t)DEPTH * 4 * 128 * 256, O_KS = O_VP + (size_t)DEPTH * 4 * 128 * 256,
                 O_VS = O_KS + (size_t)DEPTH * DB * 128 * 256, O_GV = O_VS + (size_t)DEPTH * DB * 128 * 256, O_END = O_GV + (size_t)DEPTH * DB * DS * D;
constexpr int RING_BYTES = 131072, LDS_BYTES = 147456;

struct Args { const float* in[21]; float* out; unsigned char* ws; int ph_lo, ph_hi, coop, pad; };

__device__ __forceinline__ unsigned f2bf(float f) { unsigned u = __builtin_bit_cast(unsigned, f); return (u + 0x7fffu + ((u >> 16) & 1u)) >> 16; }
__device__ __forceinline__ unsigned pk2(float lo, float hi) { return f2bf(lo) | (f2bf(hi) << 16); }
__device__ __forceinline__ float wave_sum(float v) {
#pragma unroll
    for (int o = 1; o < 64; o <<= 1) v += __shfl_xor(v, o);
    return v;
}
__device__ __forceinline__ void transpose_item(const float* W, int K, int N, bf16_t* WT, int k0, int n0, int drow0, LAS float* scr, int lane) {
#pragma unroll 8
    for (int i = 0; i < 32; ++i) { const int kk = 2 * i + (lane >> 5); scr[kk * 33 + (lane & 31)] = W[(size_t)(k0 + kk) * N + n0 + (lane & 31)]; }
    asm volatile("s_waitcnt lgkmcnt(0)" ::: "memory");
    const int c = lane & 7;
#pragma unroll
    for (int j = 0; j < 4; ++j) { const int n = (lane >> 3) + 8 * j; const LAS float* s = scr + (8 * c) * 33 + n;
        u32x4 o; o.x = pk2(s[0 * 33], s[1 * 33]); o.y = pk2(s[2 * 33], s[3 * 33]); o.z = pk2(s[4 * 33], s[5 * 33]); o.w = pk2(s[6 * 33], s[7 * 33]);
        *(u32x4*)(WT + (size_t)(drow0 + n) * K + k0 + 8 * c) = o; }
    asm volatile("s_waitcnt lgkmcnt(0)" ::: "memory");
}
__device__ __forceinline__ void row_to_bf16(const float* xrow, bf16_t* orow, int lane) {
    const f32x4* xr = (const f32x4*)xrow + lane; u32x2* o8 = (u32x2*)orow + lane;
#pragma unroll
    for (int j = 0; j < 4; ++j) { const f32x4 v = xr[64 * j]; u32x2 w; w.x = pk2(v[0], v[1]); w.y = pk2(v[2], v[3]); o8[64 * j] = w; }
}
__device__ __forceinline__ void ln_row(const float* zrow, const float* g, const float* b, float* xrow, bf16_t* brow, int lane) {
    const f32x4* zr = (const f32x4*)zrow + lane;
    f32x4 v[4]; float s = 0.f;
#pragma unroll
    for (int j = 0; j < 4; ++j) { v[j] = zr[64 * j]; s += (v[j][0] + v[j][1]) + (v[j][2] + v[j][3]); }
    const float mean = wave_sum(s) * (1.f / D); float s2 = 0.f;
#pragma unroll
    for (int j = 0; j < 4; ++j) { v[j] = v[j] - mean; s2 += (v[j][0] * v[j][0] + v[j][1] * v[j][1]) + (v[j][2] * v[j][2] + v[j][3] * v[j][3]); }
    const float rstd = 1.f / sqrtf(wave_sum(s2) * (1.f / D) + LN_EPS);
    f32x4* xo = (f32x4*)xrow + lane; u32x2* bo = (u32x2*)brow + lane;
#pragma unroll
    for (int j = 0; j < 4; ++j) { const f32x4 gg = ((const f32x4*)g)[lane + 64 * j], bb = ((const f32x4*)b)[lane + 64 * j];
        const f32x4 o = v[j] * rstd * gg + bb; xo[64 * j] = o; u32x2 w; w.x = pk2(o[0], o[1]); w.y = pk2(o[2], o[3]); bo[64 * j] = w; }
}

__device__ __forceinline__ int crow(int r, int hi) { return (r & 3) + 8 * (r >> 2) + 4 * hi; }
constexpr int KL_STRIDE = 144, VT_STRIDE = 528;
constexpr int LDS_KL = 0, LDS_VT = 256 * KL_STRIDE, LDS_BT = LDS_VT + 64 * VT_STRIDE, LDS_ATT_END = LDS_BT + 4 * 128 * 4;
constexpr int SG_STRIDE = 272;
constexpr int LDS_WL = 0, LDS_VNT = 128 * SG_STRIDE, LDS_STAT = 2 * 128 * SG_STRIDE, LDS_SGU_END = LDS_STAT + 128 * 8;
static_assert(LDS_ATT_END <= RING_BYTES && LDS_SGU_END <= RING_BYTES, "mixer LDS");

__device__ __forceinline__ int rel_bucket(int n) {
    if (n < 16) return n;
    int lg = 16 + (int)(__log2f((float)n * (1.0f / 16.0f)) * (16.0f / 3.0f));
    return lg < 31 ? lg : 31;
}
__device__ __forceinline__ void attn_core(const LAS unsigned char* KL, const LAS unsigned char* VT, const LAS float* bt, const bf16x8 (&qr)[4], int a, int tmin, int irel, float sink2, f32x16 (&o)[2], int lane) {
    const int q = lane & 31, hi = lane >> 5;
    f32x16 sc[5];
#pragma unroll
    for (int tt = 0; tt < 5; ++tt) {
#pragma unroll
        for (int r = 0; r < 16; ++r) sc[tt][r] = 0.f;
        const LAS unsigned char* kp = KL + (32 * (a + tt) + q) * KL_STRIDE + 16 * hi;
#pragma unroll
        for (int s = 0; s < 4; ++s) { const bf16x8 kf = *(const LAS bf16x8*)(kp + 32 * s); sc[tt] = MFMA32(kf, qr[s], sc[tt]); }
    }
    float mx = sink2;
#pragma unroll
    for (int tt = 0; tt < 5; ++tt) {
        const bool tok = (a + tt) >= tmin;
#pragma unroll
        for (int r = 0; r < 16; ++r) { const int dist = irel + 128 - (32 * tt + crow(r, hi));
            const bool valid = tok && dist >= 0 && dist < 128;
            const float s = valid ? sc[tt][r] + bt[dist & 127] : -1e30f;
            sc[tt][r] = s; mx = fmaxf(mx, s); }
    }
    mx = fmaxf(mx, __shfl_xor(mx, 32));
    float sum = 0.f;
#pragma unroll
    for (int tt = 0; tt < 5; ++tt)
#pragma unroll
        for (int r = 0; r < 16; ++r) { const float p = __builtin_amdgcn_exp2f(sc[tt][r] - mx); sc[tt][r] = p; sum += p; }
    sum += __shfl_xor(sum, 32);
    sum += __builtin_amdgcn_exp2f(sink2 - mx);
    const float inv = 1.0f / sum;
#pragma unroll
    for (int r = 0; r < 16; ++r) { o[0][r] = 0.f; o[1][r] = 0.f; }
#pragma unroll
    for (int tt = 0; tt < 5; ++tt)
#pragma unroll
        for (int half = 0; half < 2; ++half) {
            u32x4 pw; pw.x = pg8::cvt_pk_bf16(sc[tt][8 * half + 0], sc[tt][8 * half + 1]); pw.y = pg8::cvt_pk_bf16(sc[tt][8 * half + 2], sc[tt][8 * half + 3]);
            pw.z = pg8::cvt_pk_bf16(sc[tt][8 * half + 4], sc[tt][8 * half + 5]); pw.w = pg8::cvt_pk_bf16(sc[tt][8 * half + 6], sc[tt][8 * half + 7]);
            const bf16x8 pb = __builtin_bit_cast(bf16x8, pw);
#pragma unroll
            for (int dt = 0; dt < 2; ++dt) { const LAS unsigned char* vp = VT + (32 * dt + q) * VT_STRIDE + (32 * (a + tt) + 16 * half + 4 * hi) * 2;
                const s16x4 lo = *(const LAS s16x4*)vp, h4 = *(const LAS s16x4*)(vp + 16);
                const bf16x8 va = (bf16x8){lo[0], lo[1], lo[2], lo[3], h4[0], h4[1], h4[2], h4[3]};
                o[dt] = MFMA32(va, pb, o[dt]); }
        }
#pragma unroll
    for (int r = 0; r < 16; ++r) { o[0][r] *= inv; o[1][r] *= inv; }
}
__device__ __forceinline__ void attn_store(bf16_t* orow  , const f32x16 (&o)[2], int hi) {
#pragma unroll
    for (int dt = 0; dt < 2; ++dt)
#pragma unroll
        for (int g = 0; g < 4; ++g) { u32x2 w; w.x = pg8::cvt_pk_bf16(o[dt][4 * g], o[dt][4 * g + 1]); w.y = pg8::cvt_pk_bf16(o[dt][4 * g + 2], o[dt][4 * g + 3]);
            *(u32x2*)(orow + 32 * dt + 8 * g + 4 * hi) = w; }
}
__device__ __forceinline__ void stage_bias_table(LAS unsigned char* lds, const float* rel_bias, int kvh, int tid) {
    const int hl = tid >> 7, dist = tid & 127;
    ((LAS float*)(lds + LDS_BT))[tid] = rel_bias[rel_bucket(dist) * 16 + kvh * 4 + hl] * LOG2E;
}
__device__ __forceinline__ void vt_scatter(LAS unsigned char* lds, int key, int ch, u32x4 v) {
    LAS unsigned short* p = (LAS unsigned short*)(lds + LDS_VT + (ch * 8) * VT_STRIDE + key * 2);
    p[0 * (VT_STRIDE / 2)] = (unsigned short)(v.x & 0xffffu); p[1 * (VT_STRIDE / 2)] = (unsigned short)(v.x >> 16);
    p[2 * (VT_STRIDE / 2)] = (unsigned short)(v.y & 0xffffu); p[3 * (VT_STRIDE / 2)] = (unsigned short)(v.y >> 16);
    p[4 * (VT_STRIDE / 2)] = (unsigned short)(v.z & 0xffffu); p[5 * (VT_STRIDE / 2)] = (unsigned short)(v.z >> 16);
    p[6 * (VT_STRIDE / 2)] = (unsigned short)(v.w & 0xffffu); p[7 * (VT_STRIDE / 2)] = (unsigned short)(v.w >> 16);
}
__device__ __forceinline__ void attn_prompt_unit(LAS unsigned char* lds, int b, int c, int kvh, bf16_t* QO, const bf16_t* KB, const bf16_t* VB, const float* rel_bias, const float* sinks_l) {
    int tid_ = threadIdx.x; asm volatile("" : "+v"(tid_));
    const int tid = tid_, lane = tid & 63, wid = __builtin_amdgcn_readfirstlane(tid >> 6);
    stage_bias_table(lds, rel_bias, kvh, tid);
    const long band0 = (long)b * SEQ + (long)(c - 1) * 128;
#pragma unroll
    for (int i = 0; i < 4; ++i) { const int idx = tid + i * NTHR, key = idx >> 3, ch = idx & 7;
        u32x4 v = (u32x4){0u, 0u, 0u, 0u};
        if (c > 0 || key >= 128) v = *(const u32x4*)(KB + (band0 + key) * 256 + kvh * 64 + ch * 8);
        *(LAS u32x4*)(lds + LDS_KL + key * KL_STRIDE + ch * 16) = v; }
#pragma unroll
    for (int i = 0; i < 4; ++i) { const int idx = tid + i * NTHR, key = idx & 255, ch = idx >> 8;
        u32x4 v = (u32x4){0u, 0u, 0u, 0u};
        if (c > 0 || key >= 128) v = *(const u32x4*)(VB + (band0 + key) * 256 + kvh * 64 + ch * 8);
        vt_scatter(lds, key, ch, v); }
    __syncthreads();
    const int q = lane & 31, hi = lane >> 5, hl = wid >> 1, h = kvh * 4 + hl;
    const float sink2 = sinks_l[h] * LOG2E;
    const LAS float* bt = (const LAS float*)(lds + LDS_BT) + hl * 128;
#pragma unroll 1
    for (int pass = 0; pass < 2; ++pass) {
        const int a = (wid & 1) * 2 + pass;
        bf16_t* qrow = QO + ((long)b * SEQ + c * 128 + 32 * a + q) * 1024 + h * 64;
        bf16x8 qr[4];
#pragma unroll
        for (int s = 0; s < 4; ++s) qr[s] = *(const bf16x8*)(qrow + 16 * s + 8 * hi);
        f32x16 o[2];
        int irel = q; asm volatile("" : "+v"(irel));
        attn_core(lds + LDS_KL, lds + LDS_VT, bt, qr, a, (c == 0) ? 4 : 0, irel, sink2, o, lane);
        attn_store(qrow, o, hi);
    }
    __syncthreads();
}
__device__ __forceinline__ void attn_sample_unit(LAS unsigned char* lds, int b, int kvh, bf16_t* QO, const bf16_t* KB, const bf16_t* VB, const float* ck, const float* cv  , const float* rel_bias, const float* sinks_l) {
    int tid_ = threadIdx.x; asm volatile("" : "+v"(tid_));
    const int tid = tid_, lane = tid & 63, wid = __builtin_amdgcn_readfirstlane(tid >> 6);
    stage_bias_table(lds, rel_bias, kvh, tid);
#pragma unroll
    for (int i = 0; i < 3; ++i) { const int idx = tid + i * NTHR;
        if (idx < 1280) {
            { const int key = idx >> 3, ch = idx & 7; u32x4 v = (u32x4){0u, 0u, 0u, 0u};
              if (key < 128) { const float* p = ck + ((size_t)(b * 128 + key) * 256 + kvh * 64 + ch * 8); const f32x4 x0 = *(const f32x4*)p, x1 = *(const f32x4*)(p + 4); v = pg8::pack8(x0, x1); }
              else if (key < 136) v = *(const u32x4*)(KB + (size_t)(NPROMPT + b * 8 + key - 128) * 256 + kvh * 64 + ch * 8);
              *(LAS u32x4*)(lds + LDS_KL + key * KL_STRIDE + ch * 16) = v; }
            { const int key = idx % 160, ch = idx / 160; u32x4 v = (u32x4){0u, 0u, 0u, 0u};
              if (key < 128) { const float* p = cv + ((size_t)(b * 128 + key) * 256 + kvh * 64 + ch * 8); const f32x4 x0 = *(const f32x4*)p, x1 = *(const f32x4*)(p + 4); v = pg8::pack8(x0, x1); }
              else if (key < 136) v = *(const u32x4*)(VB + (size_t)(NPROMPT + b * 8 + key - 128) * 256 + kvh * 64 + ch * 8);
              vt_scatter(lds, key, ch, v); }
        } }
    __syncthreads();
    if (wid == 0) {
        const int q = lane & 31, hi = lane >> 5, hl = q >> 3, tok = q & 7, h = kvh * 4 + hl;
        const float sink2 = sinks_l[h] * LOG2E;
        const LAS float* bt = (const LAS float*)(lds + LDS_BT) + hl * 128;
        bf16_t* qrow = QO + (size_t)(NPROMPT + b * 8 + tok) * 1024 + h * 64;
        bf16x8 qr[4];
#pragma unroll
        for (int s = 0; s < 4; ++s) qr[s] = *(const bf16x8*)(qrow + 16 * s + 8 * hi);
        f32x16 o[2];
        attn_core(lds + LDS_KL, lds + LDS_VT, bt, qr, 0, 0, tok, sink2, o, lane);
        attn_store(qrow, o, hi);
    }
    __syncthreads();
}
__device__ __forceinline__ f32x2 vstat_row(const float* VST, int row) {
    const f32x4* p = (const f32x4*)(VST + (size_t)row * 32);
    f32x4 w[8]; float ms = 0.f;
#pragma unroll
    for (int i = 0; i < 8; ++i) { w[i] = p[i]; ms += w[i][0] + w[i][2]; }
    const float mean = ms * (1.0f / 16.0f); float m2 = 0.f;
#pragma unroll
    for (int i = 0; i < 8; ++i) { const float d0 = w[i][0] - mean, d1 = w[i][2] - mean; m2 += w[i][1] + w[i][3] + 64.0f * (d0 * d0 + d1 * d1); }
    f32x2 r; r.x = mean; r.y = 1.0f / sqrtf(m2 * (1.0f / 1024.0f) + LN_EPS); return r;
}
__device__ __forceinline__ void sgu_prompt_unit(LAS unsigned char* lds, int b, int c, int g, bf16_t* UY, const bf16_t* VG, const float* VST, const float* ws_l, const float* bs_l, const float* lng, const float* lnb) {
    int tid_ = threadIdx.x; asm volatile("" : "+v"(tid_));
    const int tid = tid_, lane = tid & 63, wid = __builtin_amdgcn_readfirstlane(tid >> 6);
    const int R0 = b * SEQ + c * 128, C0 = g * 128;
    if (tid < 128) ((LAS f32x2*)(lds + LDS_STAT))[tid] = vstat_row(VST, R0 + tid);
#pragma unroll
    for (int i = 0; i < 4; ++i) { const int idx = tid + i * NTHR, t = idx >> 4, ch = idx & 15, s0 = ch * 8;
        const float* p = ws_l + ((size_t)(g * 128 + t) * 128 + s0); f32x4 x0 = *(const f32x4*)p, x1 = *(const f32x4*)(p + 4);
#pragma unroll
        for (int e = 0; e < 4; ++e) { if (s0 + e > t) x0[e] = 0.f; if (s0 + 4 + e > t) x1[e] = 0.f; }
        *(LAS u32x4*)(lds + LDS_WL + t * SG_STRIDE + ch * 16) = pg8::pack8(x0, x1); }
    __syncthreads();
#pragma unroll
    for (int i = 0; i < 4; ++i) { const int idx = tid + i * NTHR, s = idx & 127, ch = idx >> 7, d0 = ch * 8;
        const u32x4 w = *(const u32x4*)(VG + (size_t)(R0 + s) * 1024 + C0 + d0);
        const f32x2 st = ((const LAS f32x2*)(lds + LDS_STAT))[s];
        const f32x4 g0 = *(const f32x4*)(lng + C0 + d0), g1 = *(const f32x4*)(lng + C0 + d0 + 4), b0 = *(const f32x4*)(lnb + C0 + d0), b1 = *(const f32x4*)(lnb + C0 + d0 + 4);
        float x[8]; x[0] = pg8::bf_lo(w.x); x[1] = pg8::bf_hi(w.x); x[2] = pg8::bf_lo(w.y); x[3] = pg8::bf_hi(w.y); x[4] = pg8::bf_lo(w.z); x[5] = pg8::bf_hi(w.z); x[6] = pg8::bf_lo(w.w); x[7] = pg8::bf_hi(w.w);
        LAS unsigned short* dst = (LAS unsigned short*)(lds + LDS_VNT + d0 * SG_STRIDE + s * 2);
#pragma unroll
        for (int e = 0; e < 8; ++e) { const float gg = e < 4 ? g0[e] : g1[e - 4], bb = e < 4 ? b0[e] : b1[e - 4];
            dst[e * (SG_STRIDE / 2)] = (unsigned short)f2bf((x[e] - st.x) * st.y * gg + bb); } }
    __syncthreads();
    const int q = lane & 31, hi = lane >> 5, tt = wid >> 1, dts = (wid & 1) * 2;
    f32x16 acc[2];
#pragma unroll
    for (int r = 0; r < 16; ++r) { acc[0][r] = 0.f; acc[1][r] = 0.f; }
    const int nk = 2 * tt + 2;
#pragma unroll 1
    for (int k = 0; k < nk; ++k) {
        const bf16x8 bw = *(const LAS bf16x8*)(lds + LDS_WL + (32 * tt + q) * SG_STRIDE + (16 * k + 8 * hi) * 2);
#pragma unroll
        for (int x = 0; x < 2; ++x) { const bf16x8 av = *(const LAS bf16x8*)(lds + LDS_VNT + (32 * (dts + x) + q) * SG_STRIDE + (16 * k + 8 * hi) * 2); acc[x] = MFMA32(av, bw, acc[x]); }
    }
    const int t = 32 * tt + q; const float bias = bs_l[g * 128 + t];
    bf16_t* urow = UY + (size_t)(R0 + t) * 1024 + C0;
#pragma unroll
    for (int x = 0; x < 2; ++x)
#pragma unroll
        for (int gq = 0; gq < 4; ++gq) { bf16_t* p = urow + 32 * (dts + x) + 8 * gq + 4 * hi; const u32x2 uw = *(const u32x2*)p;
            u32x2 w; w.x = pg8::cvt_pk_bf16(pg8::bf_lo(uw.x) * (acc[x][4 * gq] + bias), pg8::bf_hi(uw.x) * (acc[x][4 * gq + 1] + bias));
            w.y = pg8::cvt_pk_bf16(pg8::bf_lo(uw.y) * (acc[x][4 * gq + 2] + bias), pg8::bf_hi(uw.y) * (acc[x][4 * gq + 3] + bias)); *(u32x2*)p = w; }
    __syncthreads();
}
__device__ __forceinline__ void sgu_sample_unit(LAS unsigned char* lds, int b, bf16_t* UY, const bf16_t* VG, const float* VST, const float* ws_l, const float* bs_l, const float* lng, const float* lnb, float* ogv  ) {
    int tid_ = threadIdx.x; asm volatile("" : "+v"(tid_));
    const int tid = tid_;
    const int R0 = NPROMPT + b * 8;
    if (tid < 8) ((LAS f32x2*)(lds + LDS_STAT))[tid] = vstat_row(VST, R0 + tid);
    __syncthreads();
    const int c0 = tid * 2, g = c0 >> 7;
    const float g0 = lng[c0], g1 = lng[c0 + 1], b0 = lnb[c0], b1 = lnb[c0 + 1];
    float v0[8], v1[8];
#pragma unroll
    for (int s = 0; s < 8; ++s) { const unsigned w = *(const unsigned*)(VG + (size_t)(R0 + s) * 1024 + c0); const f32x2 st = ((const LAS f32x2*)(lds + LDS_STAT))[s];
        v0[s] = (pg8::bf_lo(w) - st.x) * st.y * g0 + b0; v1[s] = (pg8::bf_hi(w) - st.x) * st.y * g1 + b1;
        f32x2 o; o.x = v0[s]; o.y = v1[s]; *(f32x2*)(ogv + ((size_t)b * 8 + s) * 1024 + c0) = o; }
#pragma unroll
    for (int t = 0; t < 8; ++t) { float m0 = bs_l[g * 128 + t], m1 = m0;
#pragma unroll
        for (int s = 0; s <= t; ++s) { const float w = ws_l[(size_t)(g * 128 + t) * 128 + s]; m0 += w * v0[s]; m1 += w * v1[s]; }
        unsigned* p = (unsigned*)(UY + (size_t)(R0 + t) * 1024 + c0); const unsigned uw = *p;
        *p = pg8::cvt_pk_bf16(pg8::bf_lo(uw) * m0, pg8::bf_hi(uw) * m1); }
    __syncthreads();
}

typedef const __attribute__((address_space(4))) Args* kargs_t;
__device__ __forceinline__ kargs_t kargs() { kargs_t p = (kargs_t)__builtin_amdgcn_kernarg_segment_ptr(); asm volatile("" : "+s"(p)); return p; }
#ifndef PH_MASK
#define PH_MASK 0x1FF
#endif
#ifndef P2_MASK
#define P2_MASK 15
#endif
__global__ void __launch_bounds__(NTHR, 2) trunk_fwd(Args args) {
    extern __shared__ __attribute__((aligned(16))) unsigned char lds_raw[];
    LAS unsigned char* lds = (LAS unsigned char*)lds_raw;
    cg::grid_group grid = cg::this_grid();
    const int G = gridDim.x, bx = blockIdx.x;
    const int lo = args.ph_lo, hi = args.ph_hi; const bool coop = args.coop != 0;
#define IN(k) (lo <= (k) && (k) < hi)
#define EN(b) ((PH_MASK >> (b)) & 1)
#define SEAM(k) do { if (coop && IN((k) + 1)) grid.sync(); } while (0)
#define WAVE_IDS() const int tid = threadIdx.x, lane = tid & 63, wave = __builtin_amdgcn_readfirstlane(tid >> 6); const int gw = bx * NWAVES + wave, NGW = G * NWAVES; (void)lane; (void)gw; (void)NGW

    if (EN(8) && IN(0)) {
        kargs_t A = kargs(); unsigned char* ws = A->ws; float* out = A->out; WAVE_IDS();
        LAS float* scr = (LAS float*)(lds + wave * 16384);
        constexpr int I_IN = 16 * (INW / 32), I_SQ = 16 * (D / 32), I_GU = 16 * (FF / 32), I_DN = (FF / 64) * (D / 32);
        constexpr int I_LAYER = I_IN + 3 * I_SQ + 2 * I_GU + I_DN;
        for (int it = gw; it < DEPTH * I_LAYER; it += NGW) {
            const int l = it / I_LAYER; int r = it % I_LAYER;
            bf16_t* wl = (bf16_t*)(ws + WS_W + (size_t)l * W_LAYER_B);
            if (r < I_IN) { const int nblk = INW / 32, kb = r / nblk, nb = r % nblk; transpose_item(A->in[5] + (size_t)l * D * INW, D, INW, wl, 64 * kb, 32 * nb, 32 * nb, scr, lane); continue; } r -= I_IN;
            wl += (size_t)INW * D;
            if (r < 3 * I_SQ) { const int which = r / I_SQ; r %= I_SQ; const float* src = (which == 0 ? A->in[11] : which == 1 ? A->in[12] : A->in[13]) + (size_t)l * D * D;
                const int nblk = D / 32, kb = r / nblk, nb = r % nblk; transpose_item(src, D, D, wl + (size_t)which * D * D, 64 * kb, 32 * nb, 32 * nb, scr, lane); continue; } r -= 3 * I_SQ;
            wl += (size_t)3 * D * D;
            if (r < 2 * I_GU) { const int which = r / I_GU; r %= I_GU; const float* src = (which == 0 ? A->in[16] : A->in[17]) + (size_t)l * D * FF;
                const int nblk = FF / 32, kb = r / nblk, nb = r % nblk, n0 = 32 * nb; transpose_item(src, D, FF, wl, 64 * kb, n0, (n0 >> 7) * 256 + which * 128 + (n0 & 127), scr, lane); continue; } r -= 2 * I_GU;
            wl += (size_t)2 * FF * D;
            { const int nblk = D / 32, kb = r / nblk, nb = r % nblk; transpose_item(A->in[18] + (size_t)l * FF * D, FF, D, wl, 64 * kb, 32 * nb, 32 * nb, scr, lane); }
        }
        { const float* x_prompt = A->in[0]; const float* x_sample = A->in[1]; bf16_t* XB = (bf16_t*)(ws + WS_XB);
          for (int m = gw; m < NTOK; m += NGW) row_to_bf16(m < NPROMPT ? x_prompt + (size_t)m * D : x_sample + (size_t)(m - NPROMPT) * D, XB + (size_t)m * D, lane); }
        for (int it = bx; it < 2 * DEPTH * DB; it += G) { const int which = it / (DEPTH * DB), lb = it % (DEPTH * DB);
            const f32x4* src = (const f32x4*)((which ? A->in[3] : A->in[2]) + (size_t)lb * 32768 + 2048); f32x4* dst = (f32x4*)(out + (which ? O_VS : O_KS) + (size_t)lb * 32768);
            for (int i = tid; i < 7680; i += NTHR) dst[i] = src[i]; }
        __syncthreads();
        SEAM(0);
    }

#pragma unroll 1
    for (int l = 0; l < DEPTH; ++l) {
        const int P = 1 + 8 * l;
        if (EN(0) && IN(P + 0)) {
            kargs_t A = kargs(); unsigned char* ws = A->ws; float* out = A->out;
            pg8::Gemm g{(const bf16_t*)(ws + WS_XB), (const bf16_t*)(ws + WS_W + (size_t)l * W_LAYER_B), NTOK, INW, D}; pg8::StaticOrder S; S.init(NTOK, INW, G, bx);
            pg8::EpiH E{(bf16_t*)(ws + WS_U), (bf16_t*)(ws + WS_VG), (bf16_t*)(ws + WS_Q), (bf16_t*)(ws + WS_KB), (bf16_t*)(ws + WS_VB), (bf16_t*)(ws + WS_GA), (bf16_t*)(ws + WS_GB), (float*)(ws + WS_VST),
                        out + O_KP + (size_t)l * 4 * 128 * 256, out + O_VP + (size_t)l * 4 * 128 * 256, out + O_KS + (size_t)l * DB * 128 * 256, out + O_VS + (size_t)l * DB * 128 * 256};
            pg8::gemm_phase<pg8::EpiH, pg8::StaticOrder, true, true>(lds, g, S, E);
            SEAM(P + 0);
        }
        if (EN(1) && IN(P + 1)) {
            constexpr int N_AP = 512, N_SG = 1024, N_AS = 512, N_SS = 128;
#pragma unroll 1
            for (int it = bx; it < N_AP + N_SG + N_AS + N_SS; it += G) {
                kargs_t A = kargs(); unsigned char* ws = A->ws;
                bf16_t* U = (bf16_t*)(ws + WS_U); const bf16_t* VG = (const bf16_t*)(ws + WS_VG); bf16_t* Q = (bf16_t*)(ws + WS_Q); const bf16_t* KB = (const bf16_t*)(ws + WS_KB); const bf16_t* VB = (const bf16_t*)(ws + WS_VB);
                const float* VST = (const float*)(ws + WS_VST);
                int r = it;
                if (r < N_AP) { if (P2_MASK & 1) attn_prompt_unit(lds, r >> 7, (r >> 2) & 31, r & 3, Q, KB, VB, A->in[4], A->in[10] + l * 16); continue; } r -= N_AP;
                if (r < N_SG) { if (P2_MASK & 2) sgu_prompt_unit(lds, r >> 8, (r >> 3) & 31, r & 7, U, VG, VST, A->in[8] + (size_t)l * 8 * 128 * 128, A->in[9] + (size_t)l * 8 * 128, A->in[6] + l * D, A->in[7] + l * D); continue; } r -= N_SG;
                if (r < N_AS) { if (P2_MASK & 4) attn_sample_unit(lds, r >> 2, r & 3, Q, KB, VB, A->in[2] + (size_t)l * DB * 32768, A->in[3] + (size_t)l * DB * 32768, A->in[4], A->in[10] + l * 16); continue; } r -= N_AS;
                if (P2_MASK & 8) sgu_sample_unit(lds, r, U, VG, VST, A->in[8] + (size_t)l * 8 * 128 * 128, A->in[9] + (size_t)l * 8 * 128, A->in[6] + l * D, A->in[7] + l * D, A->out + O_GV + (size_t)l * DB * DS * D);
            }
            SEAM(P + 1);
        }
        if (EN(2) && IN(P + 2)) {
            { kargs_t A = kargs(); unsigned char* ws = A->ws; const bf16_t* Wpa = (const bf16_t*)(ws + WS_W + (size_t)l * W_LAYER_B) + (size_t)INW * D;
              pg8::Gemm g{(const bf16_t*)(ws + WS_U), Wpa, NTOK, D, D}; pg8::StaticOrder S; S.init(NTOK, D, G, bx); pg8::EpiGate<false> E{(const bf16_t*)(ws + WS_GA), (bf16_t*)(ws + WS_T)};
              pg8::gemm_phase<pg8::EpiGate<false>, pg8::StaticOrder, true, true>(lds, g, S, E); }
            { kargs_t A = kargs(); unsigned char* ws = A->ws; const bf16_t* Wpb = (const bf16_t*)(ws + WS_W + (size_t)l * W_LAYER_B) + (size_t)INW * D + (size_t)D * D;
              pg8::Gemm g{(const bf16_t*)(ws + WS_Q), Wpb, NTOK, D, D}; pg8::StaticOrder S; S.init(NTOK, D, G, bx); pg8::EpiGate<true> E{(const bf16_t*)(ws + WS_GB), (bf16_t*)(ws + WS_T)};
              pg8::gemm_phase<pg8::EpiGate<true>, pg8::StaticOrder, true, true>(lds, g, S, E); }
            SEAM(P + 2);
        }
        if (EN(3) && IN(P + 3)) {
            kargs_t A = kargs(); unsigned char* ws = A->ws; float* out = A->out; const bf16_t* Wo = (const bf16_t*)(ws + WS_W + (size_t)l * W_LAYER_B) + (size_t)INW * D + (size_t)2 * D * D;
            pg8::Gemm g{(const bf16_t*)(ws + WS_T), Wo, NTOK, D, D}; pg8::StaticOrder S; S.init(NTOK, D, G, bx);
            pg8::EpiRes E{l == 0 ? A->in[0] : out + O_Y, l == 0 ? A->in[1] : out + O_Y + (size_t)NPROMPT * D, (float*)(ws + WS_Z), ALPHA};
            pg8::gemm_phase<pg8::EpiRes, pg8::StaticOrder, true, true>(lds, g, S, E);
            SEAM(P + 3);
        }
        if (EN(4) && IN(P + 4)) {
            kargs_t A = kargs(); unsigned char* ws = A->ws; float* out = A->out; WAVE_IDS();
            const float* Z = (const float*)(ws + WS_Z); bf16_t* XB = (bf16_t*)(ws + WS_XB); const float* gg = A->in[14] + l * D; const float* bb = A->in[15] + l * D;
            for (int m = gw; m < NTOK; m += NGW) ln_row(Z + (size_t)m * D, gg, bb, out + O_Y + (size_t)m * D, XB + (size_t)m * D, lane);
            SEAM(P + 4);
        }
        if (EN(5) && IN(P + 5)) {
            kargs_t A = kargs(); unsigned char* ws = A->ws; const bf16_t* Wgu = (const bf16_t*)(ws + WS_W + (size_t)l * W_LAYER_B) + (size_t)INW * D + (size_t)3 * D * D;
            pg8::Gemm g{(const bf16_t*)(ws + WS_XB), Wgu, NTOK, 2 * FF, D}; pg8::StaticOrder S; S.init(NTOK, 2 * FF, G, bx);
            pg8::EpiSwiGLU E{(bf16_t*)(ws + WS_HID)};
            pg8::gemm_phase<pg8::EpiSwiGLU, pg8::StaticOrder, true, true>(lds, g, S, E);
            SEAM(P + 5);
        }
        if (EN(6) && IN(P + 6)) {
            kargs_t A = kargs(); unsigned char* ws = A->ws; float* out = A->out; const bf16_t* Wdn = (const bf16_t*)(ws + WS_W + (size_t)l * W_LAYER_B) + (size_t)INW * D + (size_t)3 * D * D + (size_t)2 * FF * D;
            pg8::Gemm g{(const bf16_t*)(ws + WS_HID), Wdn, NTOK, D, FF}; pg8::StaticOrder S; S.init(NTOK, D, G, bx);
            pg8::EpiRes E{out + O_Y, out + O_Y + (size_t)NPROMPT * D, (float*)(ws + WS_Z), ALPHA};
            pg8::gemm_phase<pg8::EpiRes, pg8::StaticOrder, true, true>(lds, g, S, E);
            SEAM(P + 6);
        }
        if (EN(7) && IN(P + 7)) {
            kargs_t A = kargs(); unsigned char* ws = A->ws; float* out = A->out; WAVE_IDS();
            const float* Z = (const float*)(ws + WS_Z); bf16_t* XB = (bf16_t*)(ws + WS_XB); const float* gg = A->in[19] + l * D; const float* bb = A->in[20] + l * D;
            for (int m = gw; m < NTOK; m += NGW) ln_row(Z + (size_t)m * D, gg, bb, out + O_Y + (size_t)m * D, XB + (size_t)m * D, lane);
            SEAM(P + 7);
        }
    }
#undef IN
#undef EN
#undef SEAM
#undef WAVE_IDS
}

#ifndef MK_ONE_LAUNCH
#define MK_ONE_LAUNCH 0
#endif
constexpr int N_PHASES = 1 + 8 * DEPTH;
extern "C" void kernel_launch(void* const* d_in, const int* in_sizes, int n_in, void* d_out, int out_size, void* d_ws, size_t ws_size, hipStream_t stream) {
    static int grid = 0;
    if (grid == 0) {
        if (n_in != 21 || (size_t)out_size != O_END || ws_size < WS_END) { fprintf(stderr, "kernel_launch: unexpected shapes: n_in %d out %d ws %zu (need %zu)\n", n_in, out_size, ws_size, (size_t)WS_END); grid = -1; return; }
        int dev = 0, cus = 0, per_cu = 0;
        if (hipGetDevice(&dev) != hipSuccess || hipDeviceGetAttribute(&cus, hipDeviceAttributeMultiprocessorCount, dev) != hipSuccess) { grid = -1; return; }
        if (hipFuncSetAttribute((const void*)trunk_fwd, hipFuncAttributeMaxDynamicSharedMemorySize, LDS_BYTES) != hipSuccess) { fprintf(stderr, "kernel_launch: hipFuncSetAttribute failed\n"); grid = -1; return; }
        if (hipOccupancyMaxActiveBlocksPerMultiprocessor(&per_cu, (const void*)trunk_fwd, NTHR, LDS_BYTES) != hipSuccess || per_cu < 1) { fprintf(stderr, "kernel_launch: occupancy query says %d\n", per_cu); per_cu = 1; }
        (void)hipGetLastError();
        grid = cus;
    }
    if (grid < 0) return;
    Args a{};
    for (int i = 0; i < 21; ++i) a.in[i] = (const float*)d_in[i];
    a.out = (float*)d_out; a.ws = (unsigned char*)d_ws;
#if MK_ONE_LAUNCH
    a.ph_lo = 0; a.ph_hi = N_PHASES; a.coop = 1;
    void* kargs[] = {&a};
    hipError_t e = hipLaunchCooperativeKernel((const void*)trunk_fwd, dim3(grid), dim3(NTHR), kargs, LDS_BYTES, stream);
    if (e != hipSuccess) fprintf(stderr, "kernel_launch: cooperative launch failed: %s (grid %d)\n", hipGetErrorString(e), grid);
#else
    for (int p = 0; p < N_PHASES; ++p) { a.ph_lo = p; a.ph_hi = p + 1; a.coop = 0; hipLaunchKernelGGL(trunk_fwd, dim3(grid), dim3(NTHR), LDS_BYTES, stream, a); }
#endif
}
```
